# Optimizing an MI355X kernel written in HIP

```python
import jax, jax.numpy as jnp
from jax import lax
import numpy as np

D_MODEL = 1024
BATCH = 32
SEQ = 256
DEPTH = 2
DEC_BATCH = 2
DEC_SEQ = 2048
PAST_LEN = 512

GRID_W = 64
HEAD_DIM = 64
N_Q_HEADS = 8
N_KV_HEADS = 2
Q_PER_KV = N_Q_HEADS // N_KV_HEADS
ATTN_W = N_Q_HEADS * HEAD_DIM
KV_W = N_KV_HEADS * HEAD_DIM
POOL_W = D_MODEL // 4
POOL_GROUPS = 4
POOL_GW = POOL_W // POOL_GROUPS
POOL_WINDOWS = (2, 4, 8, 16)
CONV_W = D_MODEL // 4
CONV_K = 3
N_BRANCH = 3
FFN_HIDDEN = -(-8 * D_MODEL // (3 * 256)) * 256
Q_BLOCK = 128
ROPE_THETA = 10000.0
ROPE_FREQS = HEAD_DIM // 4
EPS = 1e-6

OFF_CB = POOL_W
OFF_CC = OFF_CB + CONV_W
OFF_CH = OFF_CC + CONV_W
OFF_Q = OFF_CH + CONV_W
OFF_K = OFF_Q + ATTN_W
OFF_V = OFF_K + KV_W
OFF_G = OFF_V + KV_W
IN_W = OFF_G + N_BRANCH * D_MODEL

kernel_name = "hybrid_diffusion_pool_conv_gqa_step"


def rmsnorm(x, g):
    xf = x.astype(jnp.float32)
    y = xf * lax.rsqrt(jnp.mean(xf * xf, axis=-1, keepdims=True) + EPS)
    return (y * g.astype(jnp.float32)).astype(x.dtype)


def rope_tables(L):
    rows = L // GRID_W
    pos_row = jnp.repeat(jnp.arange(rows), GRID_W).astype(jnp.float32)
    pos_col = jnp.tile(jnp.arange(GRID_W), rows).astype(jnp.float32)
    inv = ROPE_THETA ** (-jnp.arange(ROPE_FREQS, dtype=jnp.float32) / ROPE_FREQS)
    ang = jnp.stack([pos_row[:, None] * inv, pos_col[:, None] * inv], axis=1)
    return jnp.cos(ang), jnp.sin(ang)


def apply_rope(x, cos, sin):
    B, L, H, _ = x.shape
    xr = x.reshape(B, L, H, 2, 2, ROPE_FREQS)
    x1, x2 = xr[..., 0, :], xr[..., 1, :]
    c = cos[None, :, None].astype(x.dtype)
    s = sin[None, :, None].astype(x.dtype)
    out = jnp.stack([x1 * c - x2 * s, x1 * s + x2 * c], axis=-2)
    return out.reshape(B, L, H, HEAD_DIM)


def pool_mixer(u, w_pool, pool_scale):
    B, L, _ = u.shape
    ug = u.reshape(B, L, POOL_GROUPS, POOL_GW)
    cs = jnp.cumsum(ug.astype(jnp.float32), axis=1)
    cs = jnp.concatenate([jnp.zeros((B, 1, POOL_GROUPS, POOL_GW), jnp.float32), cs], axis=1)
    t = jnp.arange(L)
    pooled = []
    for g, w in enumerate(POOL_WINDOWS):
        lo = jnp.clip(t - w // 2, 0, L)
        hi = jnp.clip(t + w // 2, 0, L)
        cnt = (hi - lo).astype(jnp.float32)
        pooled.append((cs[:, hi, g] - cs[:, lo, g]) / cnt[None, :, None])
    pooled = jnp.stack(pooled, axis=2).astype(u.dtype) - ug
    y = jnp.einsum('blgc,gcd->blgd', pooled, w_pool).reshape(B, L, POOL_W)
    return y * pool_scale


def dwconv3(u, conv_w):
    return lax.conv_general_dilated(u, conv_w[:, None, :].astype(u.dtype), window_strides=(1,),
                                    padding=((1, 1),), dimension_numbers=('NWC', 'WIO', 'NWC'),
                                    feature_group_count=CONV_W)


def attention(q, k, v):
    B, L, _, _ = q.shape
    nb = L // Q_BLOCK
    qb = q.reshape(B, nb, Q_BLOCK, N_KV_HEADS, Q_PER_KV, HEAD_DIM).transpose(1, 0, 2, 3, 4, 5)
    scale = HEAD_DIM ** -0.5

    def block(qblk):
        s = jnp.einsum('bqkgd,btkd->bkgqt', qblk, k, preferred_element_type=jnp.float32) * scale
        p = jax.nn.softmax(s, axis=-1).astype(v.dtype)
        return jnp.einsum('bkgqt,btkd->bqkgd', p, v)

    out = lax.map(block, qb)
    return out.transpose(1, 0, 2, 3, 4, 5).reshape(B, L, ATTN_W)


def mixer(h, p, rope, ctx_kv):
    B, L, _ = h.shape
    z = h @ p['w_in']
    u_pool, cb, cc, ch, q, k, v, gates = jnp.split(
        z, [OFF_CB, OFF_CC, OFF_CH, OFF_Q, OFF_K, OFF_V, OFF_G], axis=-1)
    pool_out = pool_mixer(u_pool, p['w_pool'], p['pool_scale'])
    conv_out = cb * dwconv3(cc * ch, p['conv_w'])
    q = rmsnorm(q.reshape(B, L, N_Q_HEADS, HEAD_DIM), p['q_norm_g'])
    k = rmsnorm(k.reshape(B, L, N_KV_HEADS, HEAD_DIM), p['k_norm_g'])
    v = v.reshape(B, L, N_KV_HEADS, HEAD_DIM)
    if rope is not None:
        q = apply_rope(q, rope[0], rope[1])
        k = apply_rope(k, rope[0], rope[1])
    if ctx_kv is None:
        k_all, v_all = k, v
    else:
        k_all = jnp.concatenate([k, ctx_kv[0]], axis=1)
        v_all = jnp.concatenate([v, ctx_kv[1]], axis=1)
    attn_out = attention(q, k_all, v_all)
    g = jax.nn.sigmoid(gates).reshape(B, L, N_BRANCH, D_MODEL)
    merged = (g[:, :, 0] * (pool_out @ p['w_br_pool'])
              + g[:, :, 1] * (conv_out @ p['w_br_conv'])
              + g[:, :, 2] * (attn_out @ p['w_br_attn']))
    return merged @ p['w_o'], k, v


def layer(x, cvec, p, rope, ctx_kv):
    mod = jax.nn.silu(cvec) @ p['w_ada'] + p['b_ada']
    sh1, sc1, g1, sh2, sc2, g2 = [m[:, None, :] for m in jnp.split(mod, 6, axis=-1)]
    h = rmsnorm(x, p['norm1_g']) * (1 + sc1) + sh1
    out, k, v = mixer(h, p, rope, ctx_kv)
    x = x + g1 * out
    h2 = rmsnorm(x, p['norm2_g']) * (1 + sc2) + sh2
    ffn = (jax.nn.silu(h2 @ p['w_gate']) * (h2 @ p['w_up'])) @ p['w_down']
    return x + g2 * ffn, k, v


def setup_inputs(seed: int = 0) -> dict:
    key = jax.random.key(seed)
    ks = jax.random.split(key, 32)
    f = jnp.float32
    n = lambda i, shape, s: jax.random.normal(ks[i], shape, f) * s
    D = D_MODEL
    return {
        'x_prompt': n(0, (BATCH, SEQ, D), 1.0),
        'x_sample': n(1, (DEC_BATCH, DEC_SEQ, D), 1.0),
        'cache_k': n(2, (DEC_BATCH, DEPTH, PAST_LEN, N_KV_HEADS, HEAD_DIM), 1.0),
        'cache_v': n(3, (DEC_BATCH, DEPTH, PAST_LEN, N_KV_HEADS, HEAD_DIM), 1.0),
        'c': n(4, (DEC_BATCH, D), 1.0),
        'c_ctx': n(5, (D,), 1.0),
        'norm1_g': 1.0 + n(6, (DEPTH, D), 0.02),
        'norm2_g': 1.0 + n(7, (DEPTH, D), 0.02),
        'w_ada': n(8, (DEPTH, D, 6 * D), 0.5 * D ** -0.5),
        'b_ada': n(9, (DEPTH, 6 * D), 0.02),
        'w_in': n(10, (DEPTH, D, IN_W), D ** -0.5),
        'w_pool': n(11, (DEPTH, POOL_GROUPS, POOL_GW, POOL_GW), POOL_GW ** -0.5),
        'pool_scale': 1.0 + n(12, (DEPTH, POOL_W), 0.02),
        'conv_w': n(13, (DEPTH, CONV_K, CONV_W), CONV_K ** -0.5),
        'q_norm_g': 1.0 + n(14, (DEPTH, HEAD_DIM), 0.02),
        'k_norm_g': 1.0 + n(15, (DEPTH, HEAD_DIM), 0.02),
        'w_br_pool': n(16, (DEPTH, POOL_W, D), POOL_W ** -0.5),
        'w_br_conv': n(17, (DEPTH, CONV_W, D), CONV_W ** -0.5),
        'w_br_attn': n(18, (DEPTH, ATTN_W, D), ATTN_W ** -0.5),
        'w_o': n(19, (DEPTH, D, D), D ** -0.5),
        'w_gate': n(20, (DEPTH, D, FFN_HIDDEN), D ** -0.5),
        'w_up': n(21, (DEPTH, D, FFN_HIDDEN), D ** -0.5),
        'w_down': n(22, (DEPTH, FFN_HIDDEN, D), FFN_HIDDEN ** -0.5),
        'final_g': 1.0 + n(23, (D,), 0.02),
    }


def reference(x_prompt, x_sample, cache_k, cache_v, c, c_ctx, norm1_g, norm2_g, w_ada, b_ada, w_in,
              w_pool, pool_scale, conv_w, q_norm_g, k_norm_g, w_br_pool, w_br_conv, w_br_attn, w_o,
              w_gate, w_up, w_down, final_g):
    stacked = {'norm1_g': norm1_g, 'norm2_g': norm2_g, 'w_ada': w_ada, 'b_ada': b_ada, 'w_in': w_in,
               'w_pool': w_pool, 'pool_scale': pool_scale, 'conv_w': conv_w, 'q_norm_g': q_norm_g,
               'k_norm_g': k_norm_g, 'w_br_pool': w_br_pool, 'w_br_conv': w_br_conv,
               'w_br_attn': w_br_attn, 'w_o': w_o, 'w_gate': w_gate, 'w_up': w_up, 'w_down': w_down}

    xp = x_prompt
    c_prompt = jnp.broadcast_to(c_ctx, (x_prompt.shape[0], D_MODEL))
    new_k, new_v = [], []
    for i in range(DEPTH):
        p = {name: w[i] for name, w in stacked.items()}
        xp, k, v = layer(xp, c_prompt, p, None, None)
        new_k.append(k)
        new_v.append(v)
    y_prompt = rmsnorm(xp, final_g)
    new_cache_k = jnp.stack(new_k, axis=1)
    new_cache_v = jnp.stack(new_v, axis=1)

    xs = x_sample
    rope = rope_tables(x_sample.shape[1])
    for i in range(DEPTH):
        p = {name: w[i] for name, w in stacked.items()}
        xs, _, _ = layer(xs, c, p, rope, (cache_k[:, i], cache_v[:, i]))
    y_sample = rmsnorm(xs, final_g)

    return (y_prompt, y_sample, new_cache_k, new_cache_v)
```

```cpp
#include <hip/hip_runtime.h>
#include <cstdio>
#include <cstdint>

#ifndef MK_SIMPLE_GEMM
#define MK_SIMPLE_GEMM 0
#endif
#ifndef MK_SIMPLE_ATTN
#define MK_SIMPLE_ATTN 1
#endif
#ifndef MK_PER_PHASE
#define MK_PER_PHASE 1
#endif

namespace pg8 {
#define PG8_LAS __attribute__((address_space(3)))
__device__ __forceinline__ int fresh_lane() { int l; asm volatile("v_mbcnt_lo_u32_b32 %0, -1, 0\n\tv_mbcnt_hi_u32_b32 %0, -1, %0" : "=v"(l)); return l; }
typedef unsigned short bf16_t;
typedef short bf16x8 __attribute__((ext_vector_type(8)));
typedef float f32x4 __attribute__((ext_vector_type(4)));
typedef unsigned u32x4 __attribute__((ext_vector_type(4)));
typedef unsigned u32x2 __attribute__((ext_vector_type(2)));
constexpr int BM = 256, BK = 64, HALF = 128, HTB = HALF * BK * 2  , STAGE_BYTES = 8 * HTB, NXCD = 8, WGM = 8;

__host__ __device__ __forceinline__ int lds_byte(int r, int c) { const int st = (r >> 4) * 2 + (c >> 5), rr = r & 15, cc = c & 31, ob = rr * 64 + cc * 2; return st * 1024 + (ob ^ (((ob >> 9) & 1) << 5)); }
__host__ __device__ __forceinline__ void stage_rc(int b, int& R, int& C) { const int st = b / 1024, sb = b % 1024, swz = sb ^ (((sb >> 9) & 1) << 5); R = (st >> 1) * 16 + swz / 64; C = (st & 1) * 32 + (swz % 64) / 2; }
__host__ __device__ __forceinline__ int perm32(int rho) { const int n = rho >> 4, i = rho & 15; return 8 * (i >> 2) + 4 * n + (i & 3); }

struct Unit { int pm, pn; };
struct Gemm { const bf16_t* A; const bf16_t* Bt; int M, N, K; };

struct StaticOrder {
    int nM, nN, nwg, G, c;
    __host__ __device__ void init(int M, int N, int G_, int c_) { nM = M / BM; nN = N / BM; nwg = nM * nN; G = G_; c = c_; }
    __host__ __device__ bool next(int i, Unit& u) const {
        const long L = (long)i * G + c; if (L >= nwg) return false;
        int wgid = (int)L; { const int q = nwg / NXCD, r = nwg % NXCD, xcd = wgid % NXCD, off = wgid / NXCD; wgid = (xcd < r ? xcd * (q + 1) : r * (q + 1) + (xcd - r) * q) + off; }
        const int nig = WGM * nN, gid = wgid / nig, fm = gid * WGM, gsz = (nM - fm) < WGM ? (nM - fm) : WGM;
        u.pm = fm + ((wgid % nig) % gsz); u.pn = (wgid % nig) / gsz; return true;
    }
    __device__ __forceinline__ void a_ready(const Unit&) const {}
    __device__ __forceinline__ void done(const Unit&) const {}
};

__device__ __forceinline__ unsigned cvt_pk_bf16(float lo, float hi) { unsigned r; asm volatile("v_cvt_pk_bf16_f32 %0, %1, %2" : "=v"(r) : "v"(lo), "v"(hi)); return r; }
__device__ __forceinline__ float bflo(unsigned w) { return __uint_as_float(w << 16); }
__device__ __forceinline__ float bfhi(unsigned w) { return __uint_as_float(w & 0xffff0000u); }
__device__ __forceinline__ float sigmoidf_(float x) { return __builtin_amdgcn_rcpf(1.0f + __expf(-x)); }
__device__ __forceinline__ u32x4 pack8(const f32x4 a, const f32x4 b) { u32x4 w; w.x = cvt_pk_bf16(a[0], a[1]); w.y = cvt_pk_bf16(a[2], a[3]); w.z = cvt_pk_bf16(b[0], b[1]); w.w = cvt_pk_bf16(b[2], b[3]); return w; }
__device__ __forceinline__ u32x2 pack4(const f32x4 a) { u32x2 w; w.x = cvt_pk_bf16(a[0], a[1]); w.y = cvt_pk_bf16(a[2], a[3]); return w; }
__device__ __forceinline__ void unpack8(const u32x4 w, f32x4& a, f32x4& b) { a[0] = bflo(w.x); a[1] = bfhi(w.x); a[2] = bflo(w.y); a[3] = bfhi(w.y); b[0] = bflo(w.z); b[1] = bfhi(w.z); b[2] = bflo(w.w); b[3] = bfhi(w.w); }

constexpr float ATT_C2 = 0.125f * 1.4426950408889634f;

struct EpiIn {
    static constexpr bool PERM = true, AFTER_DRAIN = false, HAS_MID = false;
    bf16_t *U, *CB, *CC, *CH, *Q, *KP, *VP, *KS, *VS, *G;
    float *outK, *outV;
    const float *qg, *kg, *ropeC, *ropeS;
    __device__ __forceinline__ void operator()(const f32x4 (&acc)[2][2][4][2], const Unit& u, int wr, int wc, int, int) const {
        const int lane_ = fresh_lane(), fr = lane_ & 15, fq = lane_ >> 4;
        const int pn = u.pn;
        if (pn < 4 || pn >= 7) {
            bf16_t* base; int ldc, colt; const bool sig = pn >= 7;
            if (!sig) { base = pn == 0 ? U : pn == 1 ? CB : pn == 2 ? CC : CH; ldc = 256; colt = 0; } else { base = G; ldc = 3072; colt = (pn - 7) * 256; }
            const int row0 = u.pm * BM + wr * 64 + fr, col0 = colt + wc * 32 + 8 * fq;
#pragma unroll
            for (int ai = 0; ai < 2; ++ai)
#pragma unroll
                for (int m = 0; m < 4; ++m) { bf16_t* rowp = base + (size_t)(row0 + ai * HALF + m * 16) * ldc + col0;
#pragma unroll
                    for (int bj = 0; bj < 2; ++bj) { f32x4 v0 = acc[ai][bj][m][0], v1 = acc[ai][bj][m][1];
                        if (sig) {
#pragma unroll
                            for (int e = 0; e < 4; ++e) { v0[e] = sigmoidf_(v0[e]); v1[e] = sigmoidf_(v1[e]); } }
                        *(u32x4*)(rowp + bj * HALF) = pack8(v0, v1); }
                    asm volatile("" ::: "memory"); }
        } else {
            const int kind = pn < 6 ? 0 : (wc < 2 ? 1 : 2);
            const int head = pn < 6 ? 4 * (pn - 4) + wc : (wc & 1);
            const bool sample = u.pm >= 32;
            f32x4 gam[2][2];
#pragma unroll
            for (int bj = 0; bj < 2; ++bj)
#pragma unroll
                for (int n = 0; n < 2; ++n) gam[bj][n] = (kind == 2) ? (f32x4){1.f, 1.f, 1.f, 1.f} : *(const f32x4*)((kind == 0 ? qg : kg) + 32 * bj + 16 * n + 4 * fq);
#pragma unroll
            for (int ai = 0; ai < 2; ++ai)
#pragma unroll
                for (int m = 0; m < 4; ++m) {
                    const int rl = ai * HALF + wr * 64 + m * 16 + fr;
                    f32x4 v[2][2];
#pragma unroll
                    for (int bj = 0; bj < 2; ++bj)
#pragma unroll
                        for (int n = 0; n < 2; ++n) v[bj][n] = acc[ai][bj][m][n];
                    if (kind != 2) {
                        float ss = 0.f;
#pragma unroll
                        for (int bj = 0; bj < 2; ++bj)
#pragma unroll
                            for (int n = 0; n < 2; ++n) ss += (v[bj][n][0] * v[bj][n][0] + v[bj][n][1] * v[bj][n][1]) + (v[bj][n][2] * v[bj][n][2] + v[bj][n][3] * v[bj][n][3]);
                        ss += __shfl_xor(ss, 16); ss += __shfl_xor(ss, 32);
                        const float rs = 1.0f / sqrtf(ss * (1.0f / 64.0f) + 1e-6f);
#pragma unroll
                        for (int bj = 0; bj < 2; ++bj)
#pragma unroll
                            for (int n = 0; n < 2; ++n) v[bj][n] = v[bj][n] * rs * gam[bj][n];
                        if (sample) {
                            const int t = ((u.pm - 32) * BM + rl) & 2047; const int prow = t >> 6, pcol = t & 63;
#pragma unroll
                            for (int bj = 0; bj < 2; ++bj) { const int pos = bj ? pcol : prow;
                                const f32x4 c4 = *(const f32x4*)(ropeC + pos * 16 + 4 * fq), s4 = *(const f32x4*)(ropeS + pos * 16 + 4 * fq);
                                const f32x4 x1 = v[bj][0], x2 = v[bj][1]; v[bj][0] = x1 * c4 - x2 * s4; v[bj][1] = x1 * s4 + x2 * c4; }
                        }
                    }
                    if (kind == 0) {
                        bf16_t* qp = Q + (size_t)(u.pm * BM + rl) * 512 + head * 64 + 4 * fq;
#pragma unroll
                        for (int bj = 0; bj < 2; ++bj)
#pragma unroll
                            for (int n = 0; n < 2; ++n) *(u32x2*)(qp + 32 * bj + 16 * n) = pack4(v[bj][n] * ATT_C2);
                    } else {
                        bf16_t* dstb; float* dstf = nullptr;
                        if (!sample) { dstb = (kind == 1 ? KP : VP) + (size_t)(u.pm * BM + rl) * 128 + head * 64 + 4 * fq;
                                       dstf = (kind == 1 ? outK : outV) + ((size_t)u.pm * 512 + rl) * 128 + head * 64 + 4 * fq; }
                        else { const int bs = (u.pm - 32) >> 3, t = ((u.pm - 32) * BM + rl) & 2047; dstb = (kind == 1 ? KS : VS) + ((size_t)bs * 2560 + t) * 128 + head * 64 + 4 * fq; }
#pragma unroll
                        for (int bj = 0; bj < 2; ++bj)
#pragma unroll
                            for (int n = 0; n < 2; ++n) { *(u32x2*)(dstb + 32 * bj + 16 * n) = pack4(v[bj][n]); if (dstf) *(f32x4*)(dstf + 32 * bj + 16 * n) = v[bj][n]; }
                    }
                    asm volatile("" ::: "memory");
                }
        }
    }
};

struct EpiGU {
    static constexpr bool PERM = true, AFTER_DRAIN = false, HAS_MID = false;
    bf16_t* ACT;
    __device__ __forceinline__ void operator()(const f32x4 (&acc)[2][2][4][2], const Unit& u, int wr, int wc, int, int) const {
        const int lane_ = fresh_lane(), fr = lane_ & 15, fq = lane_ >> 4;
        const int row0 = u.pm * BM + wr * 64 + fr, col0 = u.pn * HALF + wc * 32 + 8 * fq;
#pragma unroll
        for (int ai = 0; ai < 2; ++ai)
#pragma unroll
            for (int m = 0; m < 4; ++m) { bf16_t* rowp = ACT + (size_t)(row0 + ai * HALF + m * 16) * 2816 + col0;
                f32x4 o[2];
#pragma unroll
                for (int n = 0; n < 2; ++n) { const f32x4 g = acc[ai][0][m][n], up = acc[ai][1][m][n];
#pragma unroll
                    for (int e = 0; e < 4; ++e) o[n][e] = g[e] * sigmoidf_(g[e]) * up[e]; }
                *(u32x4*)rowp = pack8(o[0], o[1]); asm volatile("" ::: "memory"); }
    }
};

struct EpiMerge {
    static constexpr bool PERM = true, AFTER_DRAIN = false, HAS_MID = true;
    const bf16_t* G; bf16_t* MG;
    __device__ __forceinline__ void mid(f32x4 (&acc)[2][2][4][2], const Unit& u, int seg, int wr, int wc, int, int) const {
        const int lane_ = fresh_lane(), fr = lane_ & 15, fq = lane_ >> 4;
        const int row0 = u.pm * BM + wr * 64 + fr, col0 = u.pn * BM + wc * 32 + 8 * fq;
#pragma unroll
        for (int ai = 0; ai < 2; ++ai)
#pragma unroll
            for (int m = 0; m < 4; ++m) { const bf16_t* gp = G + (size_t)(row0 + ai * HALF + m * 16) * 3072 + col0 + seg * 1024;
#pragma unroll
                for (int bj = 0; bj < 2; ++bj) { f32x4 a0, a1, b0, b1; unpack8(*(const u32x4*)(gp + bj * HALF), a0, a1); unpack8(*(const u32x4*)(gp + 1024 + bj * HALF), b0, b1);
#pragma unroll
                    for (int e = 0; e < 4; ++e) { acc[ai][bj][m][0][e] *= a0[e] * __builtin_amdgcn_rcpf(fmaxf(b0[e], 1e-30f)); acc[ai][bj][m][1][e] *= a1[e] * __builtin_amdgcn_rcpf(fmaxf(b1[e], 1e-30f)); } }
                asm volatile("" ::: "memory"); }
    }
    __device__ __forceinline__ void operator()(const f32x4 (&acc)[2][2][4][2], const Unit& u, int wr, int wc, int, int) const {
        const int lane_ = fresh_lane(), fr = lane_ & 15, fq = lane_ >> 4;
        const int row0 = u.pm * BM + wr * 64 + fr, col0 = u.pn * BM + wc * 32 + 8 * fq;
#pragma unroll
        for (int ai = 0; ai < 2; ++ai)
#pragma unroll
            for (int m = 0; m < 4; ++m) { const size_t r = (size_t)(row0 + ai * HALF + m * 16);
#pragma unroll
                for (int bj = 0; bj < 2; ++bj) { f32x4 g0, g1; unpack8(*(const u32x4*)(G + r * 3072 + 2048 + col0 + bj * HALF), g0, g1);
                    *(u32x4*)(MG + r * 1024 + col0 + bj * HALF) = pack8(acc[ai][bj][m][0] * g0, acc[ai][bj][m][1] * g1); }
                asm volatile("" ::: "memory"); }
    }
};

struct EpiRes {
    static constexpr bool PERM = false, AFTER_DRAIN = false, HAS_MID = false;
    const float* baseP; const float* baseS; float* out; const float* gate;
    __device__ __forceinline__ void operator()(const f32x4 (&acc)[2][2][4][2], const Unit& u, int wr, int wc, int, int) const {
        const int lane_ = fresh_lane(), fr = lane_ & 15, fq = lane_ >> 4;
        const int cv = u.pm < 32 ? 0 : 1 + ((u.pm - 32) >> 3);
        const int col0 = u.pn * BM + wc * 32 + 4 * fq; const float* gp = gate + cv * 6144 + col0;
        f32x4 gv[2][2];
#pragma unroll
        for (int bj = 0; bj < 2; ++bj)
#pragma unroll
            for (int n = 0; n < 2; ++n) gv[bj][n] = *(const f32x4*)(gp + bj * HALF + n * 16);
        const float* bp0 = u.pm < 32 ? baseP + (size_t)u.pm * BM * 1024 : baseS + (size_t)(u.pm - 32) * BM * 1024;
#pragma unroll
        for (int ai = 0; ai < 2; ++ai)
#pragma unroll
            for (int m = 0; m < 4; ++m) { const int rl = ai * HALF + wr * 64 + m * 16 + fr; const float* bp = bp0 + (size_t)rl * 1024 + col0; float* op = out + (size_t)(u.pm * BM + rl) * 1024 + col0;
#pragma unroll
                for (int bj = 0; bj < 2; ++bj)
#pragma unroll
                    for (int n = 0; n < 2; ++n) *(f32x4*)(op + bj * HALF + n * 16) = *(const f32x4*)(bp + bj * HALF + n * 16) + gv[bj][n] * acc[ai][bj][m][n];
                asm volatile("" ::: "memory"); }
    }
};

template <class Epi, class Sched>
__device__ __forceinline__ void gemm_phase_simple(const Gemm g, const Sched& S, const Epi& E, const int wid) {
    const int lane = fresh_lane(), wr = wid >> 2, wc = wid & 3, fr = lane & 15, fq = lane >> 4;
    const int K = g.K; Unit u;
    for (int ui = 0; S.next(ui, u); ++ui) {
        f32x4 acc[2][2][4][2];
#pragma unroll
        for (int a = 0; a < 2; ++a)
#pragma unroll
            for (int b = 0; b < 2; ++b)
#pragma unroll
                for (int m = 0; m < 4; ++m)
#pragma unroll
                    for (int n = 0; n < 2; ++n) acc[a][b][m][n] = (f32x4){0.f, 0.f, 0.f, 0.f};
        for (int kt = 0; kt < K / 32; ++kt) {
            if constexpr (Epi::HAS_MID) { if (kt == 8 || kt == 16) E.mid(acc, u, kt == 8 ? 0 : 1, wr, wc, fr, fq); }
#pragma unroll
            for (int ai = 0; ai < 2; ++ai) {
                bf16x8 At[4];
#pragma unroll
                for (int m = 0; m < 4; ++m) At[m] = *(const bf16x8*)(g.A + (size_t)(u.pm * BM + ai * HALF + wr * 64 + m * 16 + fr) * K + kt * 32 + 8 * fq);
#pragma unroll
                for (int bj = 0; bj < 2; ++bj) {
                    bf16x8 Bt[2];
#pragma unroll
                    for (int n = 0; n < 2; ++n) { const int rho = 16 * n + fr; const int rb = u.pn * BM + bj * HALF + wc * 32 + (Epi::PERM ? perm32(rho) : rho);
                        Bt[n] = *(const bf16x8*)(g.Bt + (size_t)rb * K + kt * 32 + 8 * fq); }
#pragma unroll
                    for (int m = 0; m < 4; ++m)
#pragma unroll
                        for (int n = 0; n < 2; ++n) acc[ai][bj][m][n] = __builtin_amdgcn_mfma_f32_16x16x32_bf16(Bt[n], At[m], acc[ai][bj][m][n], 0, 0, 0);
                }
            }
        }
        E(acc, u, wr, wc, fr, fq);
    }
}

template <class Epi, class Sched, bool ALIGN_EPI = false, bool SP2 = false>
__device__ __forceinline__ void gemm_phase(PG8_LAS unsigned char* lds, const Gemm g, const Sched& S, const Epi& E, const int wid_in  ) {
    int wid_ = wid_in; asm volatile("" : "+s"(wid_)); const int wid = wid_;
    const int lane = fresh_lane(), tid = wid * 64 + lane,
              wr = wid >> 2, wc = wid & 3, fr = lane & 15, fq = lane >> 4;
    const int K = g.K, nt = K / BK;
    unsigned voffA[2], voffB[2];
#pragma unroll
    for (int i = 0; i < 2; ++i) { int R, C; stage_rc(tid * 16 + i * 8192, R, C); const int Rb = Epi::PERM ? ((R & ~31) + perm32(R & 31)) : R;
        voffA[i] = (unsigned)(R * K + C) * 2u; voffB[i] = (unsigned)(Rb * K + C) * 2u; }
    const size_t kstep = (size_t)(BK * 2);
    const size_t hstep = (size_t)HALF * K * 2;
    const size_t tstep = 2 * hstep;
    const unsigned ldsw = (unsigned)wid * 1024u;
    const int aoff = lds_byte(wr * 64 + fr, fq * 8), boff = lds_byte(wc * 32 + fr, fq * 8);
#define PG8_SA(b, h) (((b) * 2 + (h)) * HTB)
#define PG8_SB(b, h) ((4 + (b) * 2 + (h)) * HTB)
#define PG8_STAGE(bufoff, gbase, voff) do { _Pragma("unroll") for (int _i = 0; _i < 2; ++_i) \
        __builtin_amdgcn_global_load_lds((const unsigned*)((const char*)(gbase) + (voff)[_i]), (PG8_LAS unsigned*)(lds + (bufoff) + ldsw + _i * 8192), 16, 0, 0); } while (0)
#define PG8_LDA(dst, b, h) do { _Pragma("unroll") for (int m = 0; m < 4; ++m) _Pragma("unroll") for (int k = 0; k < 2; ++k) dst[m][k] = *(const PG8_LAS bf16x8*)(lds + PG8_SA(b, h) + aoff + m * 2048 + k * 1024); } while (0)
#define PG8_LDB(dst, b, h) do { _Pragma("unroll") for (int n = 0; n < 2; ++n) _Pragma("unroll") for (int k = 0; k < 2; ++k) dst[n][k] = *(const PG8_LAS bf16x8*)(lds + PG8_SB(b, h) + boff + n * 2048 + k * 1024); } while (0)
#define PG8_MMA(ai, bj, At, Bt) do { __builtin_amdgcn_s_setprio(1); _Pragma("unroll") for (int m = 0; m < 4; ++m) _Pragma("unroll") for (int n = 0; n < 2; ++n) _Pragma("unroll") for (int k = 0; k < 2; ++k) \
        acc[ai][bj][m][n] = __builtin_amdgcn_mfma_f32_16x16x32_bf16(Bt[n][k], At[m][k], acc[ai][bj][m][n], 0, 0, 0); __builtin_amdgcn_s_setprio(0); } while (0)
#define PG8_WAIT_V(n) asm volatile("s_waitcnt vmcnt(" #n ")" ::: "memory")
#define PG8_WAIT_L(n) asm volatile("s_waitcnt lgkmcnt(" #n ")" ::: "memory")
#define PG8_BAR __builtin_amdgcn_s_barrier()
#define PG8_SCHED __builtin_amdgcn_sched_barrier(0)
    Unit cur, nxt; int ui = 0;
    if (!S.next(0, cur)) return;
    f32x4 acc[2][2][4][2];
#pragma unroll
    for (int a = 0; a < 2; ++a)
#pragma unroll
        for (int b = 0; b < 2; ++b)
#pragma unroll
            for (int m = 0; m < 4; ++m)
#pragma unroll
                for (int n = 0; n < 2; ++n) acc[a][b][m][n] = (f32x4){0.f, 0.f, 0.f, 0.f};
    bf16x8 At[4][2], B0[2][2], B1[2][2];
    const char* cA = (const char*)g.A + (size_t)cur.pm * tstep; const char* cB = (const char*)g.Bt + (size_t)cur.pn * tstep;
    S.a_ready(cur);
    if constexpr (SP2) {
        PG8_STAGE(PG8_SB(0, 0), cB, voffB); PG8_STAGE(PG8_SB(0, 1), cB + hstep, voffB); PG8_STAGE(PG8_SA(0, 0), cA, voffA); PG8_STAGE(PG8_SA(0, 1), cA + hstep, voffA);
        if (wr == 1) PG8_BAR;
        PG8_WAIT_V(2); PG8_BAR;
        PG8_STAGE(PG8_SB(1, 0), cB + kstep, voffB); PG8_STAGE(PG8_SA(1, 0), cA + kstep, voffA); PG8_STAGE(PG8_SB(1, 1), cB + hstep + kstep, voffB);
        PG8_WAIT_V(6); PG8_BAR;
    } else {
        PG8_STAGE(PG8_SB(0, 0), cB, voffB); PG8_STAGE(PG8_SA(0, 0), cA, voffA); PG8_STAGE(PG8_SB(0, 1), cB + hstep, voffB); PG8_STAGE(PG8_SA(0, 1), cA + hstep, voffA);
        if (wr == 1) PG8_BAR;
        PG8_WAIT_V(4); PG8_BAR;
        PG8_STAGE(PG8_SB(1, 0), cB + kstep, voffB); PG8_STAGE(PG8_SA(1, 0), cA + kstep, voffA); PG8_STAGE(PG8_SB(1, 1), cB + hstep + kstep, voffB);
        PG8_WAIT_V(6); PG8_BAR;
    }
    for (;;) {
        const bool has_next = S.next(ui + 1, nxt);
        const char* nA = has_next ? (const char*)g.A + (size_t)nxt.pm * tstep : cA; const char* nB = has_next ? (const char*)g.Bt + (size_t)nxt.pn * tstep : cB;
        for (int t = 0; t < nt; t += 2) {
            if constexpr (Epi::HAS_MID) { if (t == 4 || t == 8) E.mid(acc, cur, t == 4 ? 0 : 1, wr, wc, fr, fq); }
            const bool last = (t == nt - 2);
            const char* a1 = cA + (size_t)(t + 1) * kstep;
            const char* a2 = last ? nA : cA + (size_t)(t + 2) * kstep; const char* b2 = last ? nB : cB + (size_t)(t + 2) * kstep;
            const char* a3 = a2 + kstep; const char* b3 = b2 + kstep;
            if (last && has_next) S.a_ready(nxt);
            if constexpr (SP2) {
            PG8_LDB(B0, 0, 0); PG8_LDB(B1, 0, 1); PG8_SCHED; PG8_LDA(At, 0, 0); PG8_STAGE(PG8_SA(1, 1), a1 + hstep, voffA);
            PG8_WAIT_V(8); PG8_WAIT_L(0); PG8_BAR; PG8_MMA(0, 0, At, B0); PG8_MMA(0, 1, At, B1); PG8_BAR; PG8_SCHED;
            PG8_LDA(At, 0, 1); PG8_STAGE(PG8_SB(0, 0), b2, voffB); PG8_STAGE(PG8_SB(0, 1), b2 + hstep, voffB); PG8_STAGE(PG8_SA(0, 0), a2, voffA);
            PG8_WAIT_V(8); PG8_WAIT_L(0); PG8_BAR; PG8_MMA(1, 0, At, B0); PG8_MMA(1, 1, At, B1); PG8_BAR; PG8_SCHED;
            PG8_LDB(B0, 1, 0); PG8_LDB(B1, 1, 1); PG8_SCHED; PG8_LDA(At, 1, 0); PG8_STAGE(PG8_SA(0, 1), a2 + hstep, voffA);
            PG8_WAIT_V(8); PG8_WAIT_L(0); PG8_BAR; PG8_MMA(0, 0, At, B0); PG8_MMA(0, 1, At, B1); PG8_BAR; PG8_SCHED;
            PG8_LDA(At, 1, 1); PG8_STAGE(PG8_SB(1, 0), b3, voffB); PG8_STAGE(PG8_SB(1, 1), b3 + hstep, voffB); PG8_STAGE(PG8_SA(1, 0), a3, voffA);
            PG8_WAIT_V(8); PG8_WAIT_L(0); PG8_BAR; PG8_MMA(1, 0, At, B0); PG8_MMA(1, 1, At, B1); PG8_BAR; PG8_SCHED;
            } else {
            PG8_LDB(B0, 0, 0); PG8_SCHED; PG8_LDA(At, 0, 0); PG8_STAGE(PG8_SA(1, 1), a1 + hstep, voffA);
            PG8_WAIT_L(8); PG8_BAR; PG8_WAIT_L(0); PG8_MMA(0, 0, At, B0); PG8_BAR; PG8_SCHED;
            PG8_LDB(B1, 0, 1); PG8_STAGE(PG8_SB(0, 0), b2, voffB);
            PG8_BAR; PG8_WAIT_L(0); PG8_MMA(0, 1, At, B1); PG8_BAR;
            PG8_LDA(At, 0, 1); PG8_STAGE(PG8_SA(0, 0), a2, voffA);
            PG8_BAR; PG8_WAIT_L(0); PG8_MMA(1, 0, At, B0); PG8_BAR; PG8_SCHED;
            PG8_STAGE(PG8_SB(0, 1), b2 + hstep, voffB);
            PG8_WAIT_V(6); PG8_BAR; PG8_MMA(1, 1, At, B1); PG8_BAR;
            PG8_LDB(B0, 1, 0); PG8_SCHED; PG8_LDA(At, 1, 0); PG8_STAGE(PG8_SA(0, 1), a2 + hstep, voffA);
            PG8_WAIT_L(8); PG8_BAR; PG8_WAIT_L(0); PG8_MMA(0, 0, At, B0); PG8_BAR; PG8_SCHED;
            PG8_LDB(B1, 1, 1); PG8_STAGE(PG8_SB(1, 0), b3, voffB);
            PG8_BAR; PG8_WAIT_L(0); PG8_MMA(0, 1, At, B1); PG8_BAR;
            PG8_LDA(At, 1, 1); PG8_STAGE(PG8_SA(1, 0), a3, voffA);
            PG8_BAR; PG8_WAIT_L(0); PG8_MMA(1, 0, At, B0); PG8_BAR; PG8_SCHED;
            PG8_STAGE(PG8_SB(1, 1), b3 + hstep, voffB);
            PG8_WAIT_V(6); PG8_BAR; PG8_MMA(1, 1, At, B1); PG8_BAR;
            }
        }
        if constexpr (ALIGN_EPI) { if (wr == 0) PG8_BAR; }
        if constexpr (!Epi::AFTER_DRAIN) { E(acc, cur, wr, wc, fr, fq); S.done(cur); }
        if (!has_next) break;
#pragma unroll
        for (int a = 0; a < 2; ++a)
#pragma unroll
            for (int b = 0; b < 2; ++b)
#pragma unroll
                for (int m = 0; m < 4; ++m)
#pragma unroll
                    for (int n = 0; n < 2; ++n) acc[a][b][m][n] = (f32x4){0.f, 0.f, 0.f, 0.f};
        cur = nxt; cA = nA; cB = nB; ++ui;
        if constexpr (ALIGN_EPI) { if (wr == 1) PG8_BAR; }
    }
    PG8_WAIT_V(0);
    if constexpr (!ALIGN_EPI) { if (wr == 0) PG8_BAR; }
    PG8_BAR;
    if constexpr (Epi::AFTER_DRAIN) { E.fused(acc, cur, wr, wc, fr, fq, lds, wid, lane); S.done(cur); }
#undef PG8_SA
#undef PG8_SB
#undef PG8_STAGE
#undef PG8_LDA
#undef PG8_LDB
#undef PG8_MMA
#undef PG8_WAIT_V
#undef PG8_WAIT_L
#undef PG8_BAR
#undef PG8_SCHED
}
}
#define GAS __attribute__((address_space(1)))
#define LAS __attribute__((address_space(3)))
typedef unsigned short bf16;
typedef unsigned v4u __attribute__((ext_vector_type(4)));
typedef float f32x4 __attribute__((ext_vector_type(4)));
typedef short bf16x8 __attribute__((ext_vector_type(8)));
typedef GAS unsigned gu32;
typedef GAS unsigned long long gu64;
#define RLX_AGENT __ATOMIC_RELAXED, __HIP_MEMORY_SCOPE_AGENT
#define LDS_WAIT() asm volatile("s_waitcnt lgkmcnt(0)" ::: "memory")
#define VM_WAIT() asm volatile("s_waitcnt vmcnt(0)" ::: "memory")
__device__ __forceinline__ unsigned long long rt() { return __builtin_amdgcn_s_memrealtime(); }
__device__ __forceinline__ unsigned f2bf(float f) { unsigned u = __builtin_bit_cast(unsigned, f); return (u + 0x7fffu + ((u >> 16) & 1u)) >> 16; }
__device__ __forceinline__ unsigned pk2(float lo, float hi) { return f2bf(lo) | (f2bf(hi) << 16); }

#define XB_TMO      128
#define XB_XCNT(j)  (256  + 64 * (j))
#define XB_XSUB(j)  (1280 + 64 * (j))
#define XB_XGEN(j)  (2304 + 64 * (j))
#define XB_TOP      3328
#define XB_TOPGEN   3392
#define XCD_BAR_WORDS 3456
#define XB_SPIN_CAP (1u << 18)

__device__ __forceinline__ unsigned xb_ld(unsigned* p)              { return __hip_atomic_load(p, __ATOMIC_RELAXED, __HIP_MEMORY_SCOPE_AGENT); }
__device__ __forceinline__ unsigned xb_add(unsigned* p, unsigned v) { return __hip_atomic_fetch_add(p, v, __ATOMIC_RELAXED, __HIP_MEMORY_SCOPE_AGENT); }
__device__ __forceinline__ unsigned xb_xcc_id() { return (unsigned)__builtin_amdgcn_s_getreg((3 << 11) | 20) & 0xFu; }
#define XB_SPIN(cond, bar) do { unsigned _sp = 0; while (cond) { __builtin_amdgcn_s_sleep(1); \
    if ((++_sp & 255u) == 0u) { if (xb_ld(&(bar)[XB_TMO])) break; if (_sp > XB_SPIN_CAP) { atomicAdd(&(bar)[XB_TMO], 1u); break; } } } } while (0)

struct XcdBarrier {
    unsigned* bar; unsigned x;
    volatile LAS unsigned* st;
};

__device__ __forceinline__ XcdBarrier xcd_barrier_post(unsigned* bar, volatile LAS unsigned* st) {
    XcdBarrier b; b.bar = bar; b.x = xb_xcc_id(); b.st = st;
    if (threadIdx.x == 0) (void)xb_add(&bar[XB_XCNT(b.x)], 1u);
    return b;
}
__device__ __forceinline__ void xcd_barrier_complete(unsigned* bar, unsigned x, unsigned& nloc, unsigned& nx) {
    const unsigned G = gridDim.x * gridDim.y * gridDim.z;
    unsigned sum, cnt, mine, sp = 0u;
    for (;;) {
        sum = 0u; cnt = 0u; mine = 0u;
#pragma unroll
        for (unsigned j = 0; j < 16; ++j) { const unsigned c = xb_ld(&bar[XB_XCNT(j)]); sum += c; cnt += (c > 0u) ? 1u : 0u; mine = (j == x) ? c : mine; }
        if (sum == G) break;
        __builtin_amdgcn_s_sleep(1);
        if ((++sp & 255u) == 0u) { if (xb_ld(&bar[XB_TMO])) break; if (sp > XB_SPIN_CAP) { atomicAdd(&bar[XB_TMO], 1u); break; } }
    }
    nloc = mine > 0u ? mine : 1u; nx = cnt > 0u ? cnt : 1u;
}

__device__ __forceinline__ void xcd_barrier(const XcdBarrier& b) {
    asm volatile("s_waitcnt vmcnt(0)" ::: "memory");
    __syncthreads();
    if (threadIdx.x == 0) {
        unsigned* bar = b.bar;
        __builtin_amdgcn_s_waitcnt(0);
        unsigned nloc = b.st[0], nx = b.st[1];
        if (nloc == 0u) { xcd_barrier_complete(bar, b.x, nloc, nx); b.st[0] = nloc; b.st[1] = nx; }
        const unsigned old = xb_add(&bar[XB_XSUB(b.x)], 1u);
        const unsigned gen = old / nloc;
        if (old + 1u == (gen + 1u) * nloc) {
            __builtin_amdgcn_fence(__ATOMIC_RELEASE, "agent");
            asm volatile("s_waitcnt vmcnt(0)" ::: "memory");
            const unsigned og = xb_add(&bar[XB_TOP], 1u);
            const unsigned tg = og / nx;
            if (og + 1u == (tg + 1u) * nx) xb_add(&bar[XB_TOPGEN], 1u);
            else XB_SPIN(xb_ld(&bar[XB_TOPGEN]) == tg, bar);
            __builtin_amdgcn_fence(__ATOMIC_ACQUIRE, "agent");
            xb_add(&bar[XB_XGEN(b.x)], 1u);
            asm volatile("s_waitcnt vmcnt(0)" ::: "memory");
        } else {
            XB_SPIN(xb_ld(&bar[XB_XGEN(b.x)]) == gen, bar);
            __builtin_amdgcn_fence(__ATOMIC_ACQUIRE, "agent");
            asm volatile("s_waitcnt vmcnt(0)" ::: "memory");
        }
    }
    __syncthreads();
}

constexpr int NWAVES = 8;
constexpr int DM = 1024, NPR = 8192, NSR = 4096, MROWS = NPR + NSR, INW = 4864, FFH = 2816, NGU = 2 * FFH;
constexpr int NPHASE = 18;
constexpr size_t MiB = 1u << 20;
constexpr size_t WS_CTL = 0, CTL_ZERO_BYTES = 1 * MiB;
constexpr size_t WS_MOD = 256 * 1024;
constexpr size_t WS_ROPE = 1 * MiB;
constexpr size_t WS_W = 2 * MiB, W_LAYER = 30 * MiB;
constexpr size_t WO_BT1 = 0, WO_BTM = 9961472, WO_BTO = WO_BTM + 2 * MiB, WO_BTGU = WO_BTO + 2 * MiB, WO_BTD = WO_BTGU + 11 * MiB;
static_assert(WO_BTD + (size_t)DM * FFH * 2 == W_LAYER, "weight map");
constexpr size_t WS_XN = 62 * MiB;
constexpr size_t WS_Q = 86 * MiB;
constexpr size_t WS_KP = 98 * MiB, WS_VP = 100 * MiB;
constexpr size_t WS_KS = 102 * MiB, KS_BYTES = 2 * 2560 * 128 * 2;
constexpr size_t WS_VS = WS_KS + 2 * KS_BYTES;
constexpr size_t WS_U = 107 * MiB, WS_CB = 113 * MiB, WS_CC = 119 * MiB, WS_CH = 125 * MiB;
constexpr size_t WS_AM = 131 * MiB;
constexpr size_t WS_G = 155 * MiB;
constexpr size_t WS_ACT = 107 * MiB;
constexpr size_t WS_END = 227 * MiB;
static_assert(WS_VS + 2 * KS_BYTES <= WS_U && WS_G + (size_t)MROWS * 3072 * 2 <= WS_END && WS_ACT + (size_t)MROWS * FFH * 2 <= WS_END, "d_ws map");
constexpr size_t OUT_K = (size_t)MROWS * DM, OUT_V = OUT_K + (size_t)32 * 2 * 256 * 128;
constexpr int CW_TMO = 0, CW_CODE = 1, CW_BAR = 4096;

constexpr int RING_OFF = 0, RING_BYTES = 131072;
constexpr int LDSCTL_OFF = RING_BYTES, MISC_OFF = LDSCTL_OFF + 320;
constexpr int LDS_BYTES = 147456;


struct Args { const float* in[24]; float* out; unsigned char* ws; int ph_lo, ph_hi; };
struct Ctx {
    LAS unsigned char* lds;
    int tid, lane, wave, vcu, G, gw, NGW;
    float* out; unsigned char* ws;
};
#define IN_XP 0
#define IN_XS 1
#define IN_CK 2
#define IN_CV 3
#define IN_C 4
#define IN_CCTX 5
#define IN_N1G 6
#define IN_N2G 7
#define IN_WADA 8
#define IN_BADA 9
#define IN_WIN 10
#define IN_WPOOL 11
#define IN_PSCALE 12
#define IN_CONVW 13
#define IN_QNG 14
#define IN_KNG 15
#define IN_WBP 16
#define IN_WBC 17
#define IN_WBA 18
#define IN_WO 19
#define IN_WG 20
#define IN_WU 21
#define IN_WD 22
#define IN_FG 23

__device__ __forceinline__ float wave_sum(float v) {
#pragma unroll
    for (int o = 1; o < 64; o <<= 1) v += __shfl_xor(v, o);
    return v;
}
__device__ __forceinline__ float siluf_(float x) { return x / (1.0f + __expf(-x)); }
__device__ __forceinline__ f32x4 ld_bf4(const bf16* p) { const unsigned long long w = *(const unsigned long long*)p; const unsigned lo = (unsigned)w, hi = (unsigned)(w >> 32);
    return (f32x4){__uint_as_float(lo << 16), __uint_as_float(lo & 0xffff0000u), __uint_as_float(hi << 16), __uint_as_float(hi & 0xffff0000u)}; }
__device__ __forceinline__ void st_bf4(bf16* p, const f32x4 v) { *(unsigned long long*)p = (unsigned long long)pk2(v[0], v[1]) | ((unsigned long long)pk2(v[2], v[3]) << 32); }

__device__ __forceinline__ void p0_transpose_item(const float* Wsrc, int ldw, int srccol0, bool perm, bf16* dest, int Kdst, LAS float* scr, int lane) {
#pragma unroll 8
    for (int i = 0; i < 32; ++i) { const int kk = 2 * i + (lane >> 5); scr[kk * 33 + (lane & 31)] = Wsrc[(size_t)kk * ldw + srccol0 + (lane & 31)]; }
    LDS_WAIT(); asm volatile("" ::: "memory");
    const int c = lane & 7;
#pragma unroll
    for (int j = 0; j < 4; ++j) { const int n = (lane >> 3) + 8 * j; const int sn = perm ? (16 * ((n >> 2) & 1) + 4 * (n >> 3) + (n & 3)) : n; const LAS float* s = scr + (8 * c) * 33 + sn;
        v4u o; o.x = pk2(s[0 * 33], s[1 * 33]); o.y = pk2(s[2 * 33], s[3 * 33]); o.z = pk2(s[4 * 33], s[5 * 33]); o.w = pk2(s[6 * 33], s[7 * 33]);
        *(GAS v4u*)(dest + (size_t)n * Kdst + 8 * c) = o; }
    LDS_WAIT(); asm volatile("" ::: "memory");
}
__device__ __forceinline__ void p0_fold_item(const float* wpool_g, const float* pscale_g, const float* wbp_g, int n0, bf16* Btm, int g, LAS float* scr, int lane) {
#pragma unroll 8
    for (int i = 0; i < 32; ++i) { const int d = 2 * i + (lane >> 5), j = lane & 31; scr[d * 32 + j] = pscale_g[d] * wbp_g[(size_t)d * 1024 + n0 + j]; }
    LDS_WAIT(); asm volatile("" ::: "memory");
    f32x4 a[8];
#pragma unroll
    for (int n4 = 0; n4 < 8; ++n4) a[n4] = (f32x4){0.f, 0.f, 0.f, 0.f};
#pragma unroll 1
    for (int q = 0; q < 16; ++q) { const f32x4 wp = *(const f32x4*)(wpool_g + (size_t)lane * 64 + 4 * q);
#pragma unroll
        for (int e = 0; e < 4; ++e)
#pragma unroll
            for (int n4 = 0; n4 < 8; ++n4) { const f32x4 t = *(const LAS f32x4*)(scr + (4 * q + e) * 32 + 4 * n4); a[n4] += t * wp[e]; }
        asm volatile("" ::: "memory"); }
#pragma unroll
    for (int n4 = 0; n4 < 8; ++n4)
#pragma unroll
        for (int e = 0; e < 4; ++e) Btm[(size_t)(n0 + 4 * n4 + e) * 1024 + 64 * g + lane] = (bf16)f2bf(a[n4][e]);
    LDS_WAIT(); asm volatile("" ::: "memory");
}
__device__ __forceinline__ void ph_prologue(Ctx& F, const Args& A) {
    LAS float* scr = (LAS float*)(F.lds + RING_OFF + F.wave * 16384);
    float* MOD = (float*)(F.ws + WS_MOD);
    constexpr int I_MOD = 768, I_W = 7680, I_CACHE = 256, I_ROPE = 16, NITEMS = I_MOD + 2 * I_W + I_CACHE + I_ROPE;
    for (int it = F.gw; it < NITEMS; it += F.NGW) {
        int r = it;
        if (r < I_MOD) {
            const int L = r / 384, rem = r % 384, jc = rem >> 4, kc = rem & 15;
            const float* W = A.in[IN_WADA] + (size_t)L * 1024 * 6144 + (size_t)(kc * 64) * 6144 + jc * 256 + 4 * F.lane;
            const float* c0 = A.in[IN_CCTX] + kc * 64; const float* c1 = A.in[IN_C] + kc * 64; const float* c2 = A.in[IN_C] + 1024 + kc * 64;
            f32x4 a0 = (f32x4){0.f, 0.f, 0.f, 0.f}, a1 = a0, a2 = a0;
#pragma unroll 4
            for (int k = 0; k < 64; ++k) { const f32x4 w = *(const f32x4*)(W + (size_t)k * 6144); a0 += w * siluf_(c0[k]); a1 += w * siluf_(c1[k]); a2 += w * siluf_(c2[k]); }
            if (kc == 0) { const f32x4 b = *(const f32x4*)(A.in[IN_BADA] + L * 6144 + jc * 256 + 4 * F.lane); a0 += b; a1 += b; a2 += b; }
            float* mp = MOD + (size_t)(L * 3) * 6144 + jc * 256 + 4 * F.lane;
#pragma unroll
            for (int e = 0; e < 4; ++e) { atomicAdd(mp + e, a0[e]); atomicAdd(mp + 6144 + e, a1[e]); atomicAdd(mp + 12288 + e, a2[e]); }
            continue;
        }
        r -= I_MOD;
        if (r < 2 * I_W) {
            const int L = r / I_W; r -= L * I_W;
            bf16* WB = (bf16*)(F.ws + WS_W + (size_t)L * W_LAYER);
            if (r < 2432) {
                const int kb = r / 152, nb = r % 152, pn = nb >> 3, gi = nb & 7, bj = gi >> 2, wc = gi & 3;
                int src0 = 32 * nb; bool perm = false;
                if (pn == 4 || pn == 5) { src0 = 1024 + 64 * (4 * (pn - 4) + wc) + 32 * bj; perm = true; }
                else if (pn == 6) { src0 = (wc < 2 ? 1536 + 64 * wc : 1664 + 64 * (wc - 2)) + 32 * bj; perm = true; }
                p0_transpose_item(A.in[IN_WIN] + (size_t)L * 1024 * INW + (size_t)(kb * 64) * INW, INW, src0, perm, (bf16*)((char*)WB + WO_BT1) + (size_t)(32 * nb) * 1024 + kb * 64, 1024, scr, F.lane);
                continue;
            }
            r -= 2432;
            if (r < 512) {
                const int kb = r >> 5, nb = r & 31; bf16* Btm = (bf16*)((char*)WB + WO_BTM);
                if (kb < 4) p0_fold_item(A.in[IN_WPOOL] + (size_t)(L * 4 + kb) * 4096, A.in[IN_PSCALE] + L * 256 + 64 * kb, A.in[IN_WBP] + (size_t)L * 256 * 1024 + (size_t)(64 * kb) * 1024, 32 * nb, Btm, kb, scr, F.lane);
                else { const float* src = kb < 8 ? A.in[IN_WBC] + (size_t)L * 256 * 1024 + (size_t)((kb - 4) * 64) * 1024 : A.in[IN_WBA] + (size_t)L * 512 * 1024 + (size_t)((kb - 8) * 64) * 1024;
                    p0_transpose_item(src, 1024, 32 * nb, false, Btm + (size_t)(32 * nb) * 1024 + kb * 64, 1024, scr, F.lane); }
                continue;
            }
            r -= 512;
            if (r < 512) { const int kb = r >> 5, nb = r & 31;
                p0_transpose_item(A.in[IN_WO] + (size_t)L * 1024 * 1024 + (size_t)(kb * 64) * 1024, 1024, 32 * nb, false, (bf16*)((char*)WB + WO_BTO) + (size_t)(32 * nb) * 1024 + kb * 64, 1024, scr, F.lane);
                continue; }
            r -= 512;
            if (r < 2816) {
                const int kb = r / 176, nb = r % 176, pn = nb >> 3, gi = nb & 7, bj = gi >> 2, wc = gi & 3;
                const float* src = (bj ? A.in[IN_WU] : A.in[IN_WG]) + (size_t)L * 1024 * FFH + (size_t)(kb * 64) * FFH;
                p0_transpose_item(src, FFH, 128 * pn + 32 * wc, false, (bf16*)((char*)WB + WO_BTGU) + (size_t)(32 * nb) * 1024 + kb * 64, 1024, scr, F.lane);
                continue;
            }
            r -= 2816;
            { const int kb = r >> 5, nb = r & 31;
              p0_transpose_item(A.in[IN_WD] + (size_t)L * FFH * 1024 + (size_t)(kb * 64) * 1024, 1024, 32 * nb, false, (bf16*)((char*)WB + WO_BTD) + (size_t)(32 * nb) * FFH + kb * 64, FFH, scr, F.lane); }
            continue;
        }
        r -= 2 * I_W;
        if (r < I_CACHE) {
            const int tens = r >> 7, rem = r & 127, L = rem >> 6, b = (rem >> 5) & 1, rb = rem & 31;
            const float* src = (tens ? A.in[IN_CV] : A.in[IN_CK]) + ((size_t)(b * 2 + L) * 512 + 16 * rb) * 128;
            bf16* dst = (bf16*)(F.ws + (tens ? WS_VS : WS_KS) + (size_t)L * KS_BYTES) + ((size_t)b * 2560 + 2048 + 16 * rb) * 128;
#pragma unroll
            for (int i = 0; i < 4; ++i) { const int idx = (i * 64 + F.lane) * 8; const f32x4 x0 = *(const f32x4*)(src + idx), x1 = *(const f32x4*)(src + idx + 4);
                v4u o; o.x = pk2(x0[0], x0[1]); o.y = pk2(x0[2], x0[3]); o.z = pk2(x1[0], x1[1]); o.w = pk2(x1[2], x1[3]); *(v4u*)(dst + idx) = o; }
            continue;
        }
        r -= I_CACHE;
        { const int e = r * 64 + F.lane, pos = e >> 4, f = e & 15;
          const float inv = exp2f(-(float)f * (13.287712379549449f / 16.0f));
          float rev = (float)pos * inv * 0.15915494309189535f; rev -= rintf(rev);
          float* rc = (float*)(F.ws + WS_ROPE); rc[e] = __builtin_amdgcn_cosf(rev); rc[1024 + e] = __builtin_amdgcn_sinf(rev); }
    }
}

__device__ __forceinline__ void ph_rownorm(Ctx& F, const Args& A, int L, int which) {
    const float* MOD = (const float*)(F.ws + WS_MOD); bf16* XN = (bf16*)(F.ws + WS_XN);
    const float* ng = (which ? A.in[IN_N2G] : A.in[IN_N1G]) + L * 1024;
    const bool from_in = (L == 0 && which == 0);
    for (int m = F.gw; m < MROWS; m += F.NGW) {
        const float* xr = from_in ? (m < NPR ? A.in[IN_XP] + (size_t)m * DM : A.in[IN_XS] + (size_t)(m - NPR) * DM) : F.out + (size_t)m * DM;
        const int cv = m < NPR ? 0 : 1 + ((m - NPR) >> 11);
        const float* mp = MOD + (size_t)(L * 3 + cv) * 6144 + (which ? 3072 : 0);
        f32x4 v[4]; float s = 0.f;
#pragma unroll
        for (int j = 0; j < 4; ++j) { v[j] = *(const f32x4*)(xr + 256 * j + 4 * F.lane); s += (v[j][0] * v[j][0] + v[j][1] * v[j][1]) + (v[j][2] * v[j][2] + v[j][3] * v[j][3]); }
        const float rstd = 1.0f / sqrtf(wave_sum(s) * (1.0f / DM) + 1e-6f);
#pragma unroll
        for (int j = 0; j < 4; ++j) { const int c = 256 * j + 4 * F.lane; const f32x4 g4 = *(const f32x4*)(ng + c), sh = *(const f32x4*)(mp + c), sc = *(const f32x4*)(mp + 1024 + c);
            st_bf4(XN + (size_t)m * DM + c, v[j] * rstd * g4 * (sc + 1.0f) + sh); }
    }
}
__device__ __forceinline__ void ph_final(Ctx& F, const Args& A) {
    const float* fg = A.in[IN_FG];
    for (int m = F.gw; m < MROWS; m += F.NGW) {
        float* xr = F.out + (size_t)m * DM; f32x4 v[4]; float s = 0.f;
#pragma unroll
        for (int j = 0; j < 4; ++j) { v[j] = *(const f32x4*)(xr + 256 * j + 4 * F.lane); s += (v[j][0] * v[j][0] + v[j][1] * v[j][1]) + (v[j][2] * v[j][2] + v[j][3] * v[j][3]); }
        const float rstd = 1.0f / sqrtf(wave_sum(s) * (1.0f / DM) + 1e-6f);
#pragma unroll
        for (int j = 0; j < 4; ++j) { const int c = 256 * j + 4 * F.lane; *(f32x4*)(xr + c) = v[j] * rstd * *(const f32x4*)(fg + c); }
    }
}
__device__ __forceinline__ void ph_poolconv(Ctx& F, const Args& A, int L) {
    const bf16* U = (const bf16*)(F.ws + WS_U); const bf16* CB = (const bf16*)(F.ws + WS_CB); const bf16* CC = (const bf16*)(F.ws + WS_CC); const bf16* CH = (const bf16*)(F.ws + WS_CH);
    bf16* AM = (bf16*)(F.ws + WS_AM); const float* cw = A.in[IN_CONVW] + L * 768;
    const int c = 4 * F.lane, hw = 1 << (F.lane >> 4);
    const f32x4 w0 = *(const f32x4*)(cw + c), w1 = *(const f32x4*)(cw + 256 + c), w2 = *(const f32x4*)(cw + 512 + c);
    for (int r = F.gw; r < MROWS; r += F.NGW) {
        int s0, Ls; if (r < NPR) { s0 = r & ~255; Ls = 256; } else { s0 = NPR + ((r - NPR) & ~2047); Ls = 2048; }
        const int t = r - s0; const int lo = t - hw < 0 ? 0 : t - hw, hi = t + hw > Ls ? Ls : t + hw;
        f32x4 sum = (f32x4){0.f, 0.f, 0.f, 0.f};
        for (int tt = lo; tt < hi; ++tt) sum += ld_bf4(U + (size_t)(s0 + tt) * 256 + c);
        const f32x4 pooled = sum * (1.0f / (float)(hi - lo)) - ld_bf4(U + (size_t)r * 256 + c);
        st_bf4(AM + (size_t)r * 1024 + c, pooled);
        f32x4 o = ld_bf4(CC + (size_t)r * 256 + c) * ld_bf4(CH + (size_t)r * 256 + c) * w1;
        if (t > 0) o += ld_bf4(CC + (size_t)(r - 1) * 256 + c) * ld_bf4(CH + (size_t)(r - 1) * 256 + c) * w0;
        if (t + 1 < Ls) o += ld_bf4(CC + (size_t)(r + 1) * 256 + c) * ld_bf4(CH + (size_t)(r + 1) * 256 + c) * w2;
        st_bf4(AM + (size_t)r * 1024 + 256 + c, o * ld_bf4(CB + (size_t)r * 256 + c));
    }
}
__device__ __forceinline__ void ph_attn_simple(Ctx& F, int L) {
    const bf16* Q = (const bf16*)(F.ws + WS_Q); bf16* AM = (bf16*)(F.ws + WS_AM);
    const int fr = F.lane & 15, fq = F.lane >> 4;
    constexpr int NU_S = 2 * 8 * 128, NU_P = 32 * 8 * 16;
    for (int un = F.gw; un < NU_S + NU_P; un += F.NGW) {
        int qrow0, h, nkeys; const bf16 *Kb, *Vb;
        if (un < NU_S) { const int b = un >> 10, rem = un & 1023; h = rem >> 7; const int qb = rem & 127; qrow0 = NPR + b * 2048 + qb * 16; nkeys = 2560;
            Kb = (const bf16*)(F.ws + WS_KS + (size_t)L * KS_BYTES) + (size_t)b * 2560 * 128; Vb = (const bf16*)(F.ws + WS_VS + (size_t)L * KS_BYTES) + (size_t)b * 2560 * 128; }
        else { const int v = un - NU_S; const int b = v >> 7, rem = v & 127; h = rem >> 4; const int qb = rem & 15; qrow0 = b * 256 + qb * 16; nkeys = 256;
            Kb = (const bf16*)(F.ws + WS_KP) + (size_t)b * 256 * 128; Vb = (const bf16*)(F.ws + WS_VP) + (size_t)b * 256 * 128; }
        const int kvh = h >> 2; Kb += kvh * 64; Vb += kvh * 64;
        bf16x8 qf[2];
#pragma unroll
        for (int ks = 0; ks < 2; ++ks) qf[ks] = *(const bf16x8*)(Q + (size_t)(qrow0 + fr) * 512 + h * 64 + ks * 32 + 8 * fq);
        float mrun = -1e30f, lrun = 0.f; f32x4 o[4];
#pragma unroll
        for (int d = 0; d < 4; ++d) o[d] = (f32x4){0.f, 0.f, 0.f, 0.f};
        for (int key0 = 0; key0 < nkeys; key0 += 32) {
            f32x4 s[2];
#pragma unroll
            for (int a = 0; a < 2; ++a) { s[a] = (f32x4){0.f, 0.f, 0.f, 0.f};
#pragma unroll
                for (int ks = 0; ks < 2; ++ks) { const bf16x8 kf = *(const bf16x8*)(Kb + (size_t)(key0 + 16 * a + fr) * 128 + ks * 32 + 8 * fq);
                    s[a] = __builtin_amdgcn_mfma_f32_16x16x32_bf16(kf, qf[ks], s[a], 0, 0, 0); } }
            float mx = fmaxf(fmaxf(fmaxf(s[0][0], s[0][1]), fmaxf(s[0][2], s[0][3])), fmaxf(fmaxf(s[1][0], s[1][1]), fmaxf(s[1][2], s[1][3])));
            mx = fmaxf(mx, __shfl_xor(mx, 16)); mx = fmaxf(mx, __shfl_xor(mx, 32));
            const float mnew = fmaxf(mrun, mx), alpha = exp2f(mrun - mnew);
            float ps = 0.f;
#pragma unroll
            for (int a = 0; a < 2; ++a)
#pragma unroll
                for (int e = 0; e < 4; ++e) { s[a][e] = exp2f(s[a][e] - mnew); ps += s[a][e]; }
            ps += __shfl_xor(ps, 16); ps += __shfl_xor(ps, 32);
            lrun = lrun * alpha + ps; mrun = mnew;
            bf16x8 pf; { const v4u w = __builtin_bit_cast(v4u, pg8::pack8(s[0], s[1])); pf = __builtin_bit_cast(bf16x8, w); }
#pragma unroll
            for (int d = 0; d < 4; ++d) { o[d] = o[d] * alpha; bf16x8 vf;
#pragma unroll
                for (int j = 0; j < 8; ++j) vf[j] = (short)Vb[(size_t)(key0 + 16 * (j >> 2) + 4 * fq + (j & 3)) * 128 + d * 16 + fr];
                o[d] = __builtin_amdgcn_mfma_f32_16x16x32_bf16(vf, pf, o[d], 0, 0, 0); }
        }
        const float rl = 1.0f / lrun;
#pragma unroll
        for (int d = 0; d < 4; ++d) st_bf4(AM + (size_t)(qrow0 + fr) * 1024 + 512 + h * 64 + d * 16 + 4 * fq, o[d] * rl);
    }
}

template <class Epi>
__device__ __forceinline__ void run_gemm(Ctx& F, const pg8::Gemm& g, const Epi& E) {
    pg8::StaticOrder S; S.init(g.M, g.N, F.G, (int)blockIdx.x);
#if MK_SIMPLE_GEMM
    pg8::gemm_phase_simple<Epi, pg8::StaticOrder>(g, S, E, F.wave);
#else
    pg8::gemm_phase<Epi, pg8::StaticOrder, true, true>(F.lds + RING_OFF, g, S, E, F.wave);
#endif
}
__device__ __forceinline__ void ph_gemm1(Ctx& F, const Args& A, int L) {
    const bf16* WB = (const bf16*)(F.ws + WS_W + (size_t)L * W_LAYER);
    pg8::Gemm g{(const bf16*)(F.ws + WS_XN), (const bf16*)((const char*)WB + WO_BT1), MROWS, INW, DM};
    pg8::EpiIn E;
    E.U = (bf16*)(F.ws + WS_U); E.CB = (bf16*)(F.ws + WS_CB); E.CC = (bf16*)(F.ws + WS_CC); E.CH = (bf16*)(F.ws + WS_CH); E.Q = (bf16*)(F.ws + WS_Q);
    E.KP = (bf16*)(F.ws + WS_KP); E.VP = (bf16*)(F.ws + WS_VP); E.KS = (bf16*)(F.ws + WS_KS + (size_t)L * KS_BYTES); E.VS = (bf16*)(F.ws + WS_VS + (size_t)L * KS_BYTES);
    E.G = (bf16*)(F.ws + WS_G); E.outK = F.out + OUT_K + (size_t)L * 256 * 128; E.outV = F.out + OUT_V + (size_t)L * 256 * 128;
    E.qg = A.in[IN_QNG] + L * 64; E.kg = A.in[IN_KNG] + L * 64; E.ropeC = (const float*)(F.ws + WS_ROPE); E.ropeS = E.ropeC + 1024;
    run_gemm(F, g, E);
}
__device__ __forceinline__ void ph_merge(Ctx& F, int L) {
    const bf16* WB = (const bf16*)(F.ws + WS_W + (size_t)L * W_LAYER);
    pg8::Gemm g{(const bf16*)(F.ws + WS_AM), (const bf16*)((const char*)WB + WO_BTM), MROWS, DM, DM};
    pg8::EpiMerge E{(const bf16*)(F.ws + WS_G), (bf16*)(F.ws + WS_XN)};
    run_gemm(F, g, E);
}
__device__ __forceinline__ void ph_wo(Ctx& F, const Args& A, int L) {
    const bf16* WB = (const bf16*)(F.ws + WS_W + (size_t)L * W_LAYER);
    pg8::Gemm g{(const bf16*)(F.ws + WS_XN), (const bf16*)((const char*)WB + WO_BTO), MROWS, DM, DM};
    const float* MOD = (const float*)(F.ws + WS_MOD);
    pg8::EpiRes E{L == 0 ? A.in[IN_XP] : F.out, L == 0 ? A.in[IN_XS] : F.out + (size_t)NPR * DM, F.out, MOD + (size_t)(L * 3) * 6144 + 2048};
    run_gemm(F, g, E);
}
__device__ __forceinline__ void ph_gateup(Ctx& F, int L) {
    const bf16* WB = (const bf16*)(F.ws + WS_W + (size_t)L * W_LAYER);
    pg8::Gemm g{(const bf16*)(F.ws + WS_XN), (const bf16*)((const char*)WB + WO_BTGU), MROWS, NGU, DM};
    pg8::EpiGU E{(bf16*)(F.ws + WS_ACT)};
    run_gemm(F, g, E);
}
__device__ __forceinline__ void ph_down(Ctx& F, int L) {
    const bf16* WB = (const bf16*)(F.ws + WS_W + (size_t)L * W_LAYER);
    pg8::Gemm g{(const bf16*)(F.ws + WS_ACT), (const bf16*)((const char*)WB + WO_BTD), MROWS, DM, FFH};
    const float* MOD = (const float*)(F.ws + WS_MOD);
    pg8::EpiRes E{F.out, F.out + (size_t)NPR * DM, F.out, MOD + (size_t)(L * 3) * 6144 + 5120};
    run_gemm(F, g, E);
}

#ifdef MK_ONLY
#define ONLY(x) (MK_ONLY == (x))
#else
#define ONLY(x) true
#endif
__global__ void __launch_bounds__(NWAVES * 64, 2) mk_fwd(Args args) {
    extern __shared__ __attribute__((aligned(16))) unsigned char lds[];
    Ctx F;
    F.lds = (LAS unsigned char*)lds;
    F.tid = threadIdx.x; F.lane = F.tid & 63; F.wave = __builtin_amdgcn_readfirstlane(F.tid >> 6);
    F.G = gridDim.x; { const int bx = blockIdx.x; F.vcu = (F.G % 8 == 0) ? (bx % 8) * (F.G / 8) + bx / 8 : bx; }
    F.gw = F.vcu * NWAVES + F.wave; F.NGW = F.G * NWAVES;
    F.out = args.out; F.ws = args.ws;
    volatile LAS unsigned* MISC = (volatile LAS unsigned*)(F.lds + MISC_OFF);
    for (int u = F.tid; u < (LDS_BYTES - LDSCTL_OFF) / 4; u += NWAVES * 64) ((LAS unsigned*)(F.lds + LDSCTL_OFF))[u] = 0u;
    __syncthreads();
    gu32* ctl = (gu32*)(F.ws + WS_CTL);
#if !MK_PER_PHASE
    XcdBarrier bar = xcd_barrier_post((unsigned*)(ctl + CW_BAR), MISC + 8);
#endif
    for (int ph = args.ph_lo; ph < args.ph_hi; ++ph) {
        F.lane = pg8::fresh_lane(); F.tid = F.wave * 64 + F.lane;
#if !MK_PER_PHASE
        if (ph > args.ph_lo) xcd_barrier(bar);
#endif
        if (ph == 0) { if (ONLY(100)) ph_prologue(F, args); continue; }
        int L = 0, s = 8;
        if (ph >= 2) { L = (ph - 2) >> 3; s = (ph - 2) & 7; }
        if (s == 8 || s == 4 || (s == 7 && L == 0)) { if (ONLY(101)) ph_rownorm(F, args, s == 7 ? 1 : L, s == 4 ? 1 : 0); continue; }
        switch (s) {
            case 0: if (ONLY(0)) ph_gemm1(F, args, L); break;
            case 1: if (ONLY(102)) ph_poolconv(F, args, L); if (ONLY(1))
#if MK_SIMPLE_ATTN
                    ph_attn_simple(F, L);
#else
                    ph_attn(F, L);
#endif
                    break;
            case 2: if (ONLY(2)) ph_merge(F, L); break;
            case 3: if (ONLY(3)) ph_wo(F, args, L); break;
            case 5: if (ONLY(5)) ph_gateup(F, L); break;
            case 6: if (ONLY(6)) ph_down(F, L); break;
            default: if (ONLY(103)) ph_final(F, args); break;
        }
    }
}

extern "C" void kernel_launch(void* const* d_in, const int* in_sizes, int n_in, void* d_out, int out_size, void* d_ws, size_t ws_size, hipStream_t stream) {
    static int grid = 0;
    if (grid == 0) {
        if (n_in != 24 || out_size != (int)(OUT_V + (size_t)32 * 2 * 256 * 128) || ws_size < WS_END) { fprintf(stderr, "kernel_launch: unexpected problem shape (n_in %d, out %d, ws %zu); nothing launched\n", n_in, out_size, ws_size); grid = -1; return; }
        int dev = 0, cus = 0, per_cu = 0;
        if (hipGetDevice(&dev) != hipSuccess || hipDeviceGetAttribute(&cus, hipDeviceAttributeMultiprocessorCount, dev) != hipSuccess) { grid = -1; return; }
        if (hipFuncSetAttribute((const void*)mk_fwd, hipFuncAttributeMaxDynamicSharedMemorySize, LDS_BYTES) != hipSuccess) { fprintf(stderr, "kernel_launch: hipFuncSetAttribute failed\n"); grid = -1; return; }
        if (hipOccupancyMaxActiveBlocksPerMultiprocessor(&per_cu, (const void*)mk_fwd, NWAVES * 64, LDS_BYTES) != hipSuccess || per_cu < 1) { fprintf(stderr, "kernel_launch: occupancy query reports %d blocks per CU\n", per_cu); per_cu = 1; }
        (void)hipGetLastError();
        grid = cus;
    }
    if (grid < 0) return;
    (void)hipMemsetAsync((char*)d_ws + WS_CTL, 0, CTL_ZERO_BYTES, stream);
    Args a{};
    for (int i = 0; i < 24; ++i) a.in[i] = (const float*)d_in[i];
    a.out = (float*)d_out; a.ws = (unsigned char*)d_ws;
#if MK_PER_PHASE
    for (int ph = 0; ph < NPHASE; ++ph) { a.ph_lo = ph; a.ph_hi = ph + 1; hipLaunchKernelGGL(mk_fwd, dim3(grid), dim3(NWAVES * 64), LDS_BYTES, stream, a); }
#else
    a.ph_lo = 0; a.ph_hi = NPHASE;
    hipLaunchKernelGGL(mk_fwd, dim3(grid), dim3(NWAVES * 64), LDS_BYTES, stream, a);
#endif
}
```
